# Optimizing an MI355X kernel written in HIP

```python
import jax, jax.numpy as jnp
from jax import lax
import numpy as np

D_MODEL = 1024
BATCH = 16
SEQ = 2048
DEPTH = 1

HEAD_DIM = 64
N_HEADS_A = 8
N_HEADS_B = 8
D_A = N_HEADS_A * HEAD_DIM
D_B = N_HEADS_B * HEAD_DIM
D_MIX = D_A + D_B
DILATED_PATTERNS = ((128, 1), (512, 4), (2048, 16))
MOBA_BLOCK = 256
MOBA_TOPK = 3
MOBA_Q_CHUNK = 128
ROPE_THETA = 10000.0
LN_EPS = 1e-5
NEG_INF = -1e30
DEEPNORM_ALPHA = (2.0 * DEPTH) ** 0.25
DEEPNORM_BETA = (8.0 * DEPTH) ** -0.25

kernel_name = "hybrid_dilated_moba_gated_deepnorm"


def _layernorm(x, g, b):
    xf = x.astype(jnp.float32)
    mu = xf.mean(-1, keepdims=True)
    var = jnp.square(xf - mu).mean(-1, keepdims=True)
    return ((xf - mu) * lax.rsqrt(var + LN_EPS) * g + b).astype(x.dtype)


def _rope(t, pos):
    half = HEAD_DIM // 2
    inv = ROPE_THETA ** (-jnp.arange(half, dtype=jnp.float32) / half)
    ang = pos.astype(jnp.float32)[:, None] * inv[None, :]
    cos, sin = jnp.cos(ang), jnp.sin(ang)
    t1, t2 = t[..., :half], t[..., half:]
    return jnp.concatenate([t1 * cos - t2 * sin, t1 * sin + t2 * cos], axis=-1).astype(t.dtype)


def _split_heads(t, n_heads):
    B, S, _ = t.shape
    return t.reshape(B, S, n_heads, HEAD_DIM).transpose(0, 2, 1, 3)


def _merge_heads(t):
    B, H, S, D = t.shape
    return t.transpose(0, 2, 1, 3).reshape(B, S, H * D)


def _dilated_window_attention(q, k, v, window, dilation):
    B, H, S, D = q.shape
    d = dilation
    w = window // d
    L = -(-S // d)
    Sp = L * d
    nb = -(-L // w)
    Lp = nb * w

    def to_classes(t):
        t = jnp.pad(t, ((0, 0), (0, 0), (0, Sp - S), (0, 0)))
        return t.reshape(B, H, L, d, D).transpose(0, 1, 3, 2, 4)

    qc, kc, vc = to_classes(q), to_classes(k), to_classes(v)
    qb = jnp.pad(qc, ((0, 0), (0, 0), (0, 0), (0, Lp - L), (0, 0))).reshape(B, H, d, nb, w, D)

    def key_bands(t):
        t = jnp.pad(t, ((0, 0), (0, 0), (0, 0), (w, Lp - L), (0, 0))).reshape(B, H, d, nb + 1, w, D)
        return jnp.concatenate([t[:, :, :, :-1], t[:, :, :, 1:]], axis=4)

    kb, vb = key_bands(kc), key_bands(vc)
    s = jnp.einsum('bhrnqd,bhrnkd->bhrnqk', qb, kb,
                   preferred_element_type=jnp.float32) * (HEAD_DIM ** -0.5)
    i = jnp.arange(w)[None, :, None]
    j = jnp.arange(2 * w)[None, None, :]
    n = jnp.arange(nb)[:, None, None]
    dist = i + w - j
    key_idx = n * w + j - w
    valid = (dist >= 0) & (dist <= w) & (key_idx >= 0)
    s = jnp.where(valid, s, NEG_INF)
    m = s.max(-1, keepdims=True)
    p = jnp.exp(s - m)
    l = p.sum(-1, keepdims=True)
    o = jnp.einsum('bhrnqk,bhrnkd->bhrnqd', (p / l).astype(v.dtype), vb)
    lse = (m + jnp.log(l))[..., 0]
    o = o.reshape(B, H, d, Lp, D)[:, :, :, :L].transpose(0, 1, 3, 2, 4).reshape(B, H, Sp, D)[:, :, :S]
    lse = lse.reshape(B, H, d, Lp)[..., :L].transpose(0, 1, 3, 2).reshape(B, H, Sp)[:, :, :S]
    return o, lse


def _dilated_mixture(q, k, v):
    outs, lses = [], []
    for window, dilation in DILATED_PATTERNS:
        o, lse = _dilated_window_attention(q, k, v, window, dilation)
        outs.append(o)
        lses.append(lse)
    wts = jax.nn.softmax(jnp.stack(lses, axis=0), axis=0)
    o = jnp.stack(outs, axis=0).astype(jnp.float32)
    return jnp.sum(wts[..., None] * o, axis=0).astype(q.dtype)


def _moba_attention(q, k, v):
    B, H, S, D = q.shape
    BS, QC = MOBA_BLOCK, MOBA_Q_CHUNK
    nb = -(-S // BS)
    Sp = nb * BS
    nq = Sp // QC
    topk = min(MOBA_TOPK, nb)
    pad = ((0, 0), (0, 0), (0, Sp - S), (0, 0))
    q, k, v = jnp.pad(q, pad), jnp.pad(k, pad), jnp.pad(v, pad)
    kb = k.reshape(B, H, nb, BS, D)
    vb = v.reshape(B, H, nb, BS, D)
    k_mean = kb.astype(jnp.float32).mean(axis=3)
    gate = jnp.einsum('bhsd,bhnd->bhsn', q.astype(jnp.float32), k_mean)
    own = jnp.arange(Sp) // BS
    past = jnp.arange(nb)[None, :] < own[:, None]
    gate = jnp.where(past, gate, NEG_INF)
    _, sel = lax.top_k(gate, topk)

    q_c = q.reshape(B, H, nq, QC, D).transpose(0, 2, 1, 3, 4).reshape(B * nq, H, QC, D)
    sel_c = sel.reshape(B, H, nq, QC, topk).transpose(0, 2, 1, 3, 4).reshape(B * nq, H, QC, topk)
    b_ids = jnp.repeat(jnp.arange(B, dtype=jnp.int32), nq)
    c_ids = jnp.tile(jnp.arange(nq, dtype=jnp.int32), B)
    h_ids = jnp.arange(H)[:, None, None]
    scale = HEAD_DIM ** -0.5

    def chunk(args):
        b_idx, c_idx, q_i, sel_i = args
        kb_b, vb_b = kb[b_idx], vb[b_idx]
        own_blk = (c_idx * QC) // BS
        k_sel = kb_b[h_ids, sel_i]
        v_sel = vb_b[h_ids, sel_i]
        k_own = lax.dynamic_index_in_dim(kb_b, own_blk, axis=1, keepdims=False)
        v_own = lax.dynamic_index_in_dim(vb_b, own_blk, axis=1, keepdims=False)
        s_sel = jnp.einsum('hqd,hqtkd->hqtk', q_i, k_sel, preferred_element_type=jnp.float32) * scale
        s_sel = jnp.where((sel_i < own_blk)[..., None], s_sel, NEG_INF).reshape(H, QC, topk * BS)
        s_own = jnp.einsum('hqd,hkd->hqk', q_i, k_own, preferred_element_type=jnp.float32) * scale
        qpos = c_idx * QC + jnp.arange(QC)
        kpos = own_blk * BS + jnp.arange(BS)
        s_own = jnp.where(kpos[None, :] <= qpos[:, None], s_own, NEG_INF)
        p = jax.nn.softmax(jnp.concatenate([s_sel, s_own], axis=-1), axis=-1).astype(v.dtype)
        p_sel = p[..., :topk * BS].reshape(H, QC, topk, BS)
        p_own = p[..., topk * BS:]
        return (jnp.einsum('hqtk,hqtkd->hqd', p_sel, v_sel)
                + jnp.einsum('hqk,hkd->hqd', p_own, v_own))

    o = lax.map(chunk, (b_ids, c_ids, q_c, sel_c))
    o = o.reshape(B, nq, H, QC, D).transpose(0, 2, 1, 3, 4).reshape(B, H, Sp, D)
    return o[:, :, :S]


def setup_inputs(seed: int = 0) -> dict:
    key = jax.random.key(seed)
    ks = jax.random.split(key, 8)
    x = jax.random.normal(ks[0], (BATCH, SEQ, D_MODEL), jnp.float32)
    c = jax.random.normal(ks[1], (BATCH, D_MODEL), jnp.float32)
    col_scale = jnp.concatenate([
        jnp.ones((3 * D_A,), jnp.float32).at[2 * D_A:].set(DEEPNORM_BETA),
        jnp.ones((D_A,), jnp.float32),
        jnp.ones((3 * D_B,), jnp.float32).at[2 * D_B:].set(DEEPNORM_BETA),
        jnp.ones((D_B,), jnp.float32)])
    w_in = jax.random.normal(ks[2], (DEPTH, D_MODEL, 4 * D_MIX), jnp.float32) * (D_MODEL ** -0.5) * col_scale
    w_out = jax.random.normal(ks[3], (DEPTH, D_MIX, D_MODEL), jnp.float32) * (D_MIX ** -0.5) * DEEPNORM_BETA
    w_ada = jax.random.normal(ks[4], (DEPTH, D_MODEL, 3 * D_MODEL), jnp.float32) * (0.5 * D_MODEL ** -0.5)
    b_ada = 0.02 * jax.random.normal(ks[5], (DEPTH, 3 * D_MODEL), jnp.float32)
    ln_g = 1.0 + 0.02 * jax.random.normal(ks[6], (DEPTH, D_MODEL), jnp.float32)
    ln_b = 0.02 * jax.random.normal(ks[7], (DEPTH, D_MODEL), jnp.float32)
    return {"x": x, "c": c, "w_in": w_in, "w_out": w_out, "w_ada": w_ada,
            "b_ada": b_ada, "ln_g": ln_g, "ln_b": ln_b}


def reference(x, c, w_in, w_out, w_ada, b_ada, ln_g, ln_b):
    B, S, _ = x.shape
    pos = jnp.arange(S, dtype=jnp.int32)
    offs = np.cumsum([0, D_A, D_A, D_A, D_A, D_B, D_B, D_B])[1:].tolist()
    for layer in range(DEPTH):
        mod = c @ w_ada[layer] + b_ada[layer]
        shift, scale, gate = jnp.split(mod, 3, axis=-1)
        h = x * (1.0 + scale[:, None, :]) + shift[:, None, :]
        proj = h @ w_in[layer]
        qa, ka, va, ga, qb, kb, vb, gb = jnp.split(proj, offs, axis=-1)
        qa, ka, va = _split_heads(qa, N_HEADS_A), _split_heads(ka, N_HEADS_A), _split_heads(va, N_HEADS_A)
        qb, kb, vb = _split_heads(qb, N_HEADS_B), _split_heads(kb, N_HEADS_B), _split_heads(vb, N_HEADS_B)
        qa, ka, qb, kb = _rope(qa, pos), _rope(ka, pos), _rope(qb, pos), _rope(kb, pos)
        o_a = _merge_heads(_dilated_mixture(qa, ka, va)) * jax.nn.silu(ga)
        o_b = _merge_heads(_moba_attention(qb, kb, vb)) * jax.nn.silu(gb)
        y = jnp.concatenate([o_a, o_b], axis=-1) @ w_out[layer]
        x = _layernorm(DEEPNORM_ALPHA * x + gate[:, None, :] * y, ln_g[layer], ln_b[layer])
    return x
```

```cpp
#include <hip/hip_runtime.h>
#include <hip/hip_cooperative_groups.h>
#include <cstdio>
namespace cg = cooperative_groups;
namespace pg8 {
#define PG8_LAS __attribute__((address_space(3)))
typedef unsigned short bf16_t;
typedef short bf16x8 __attribute__((ext_vector_type(8)));
typedef float f32x4 __attribute__((ext_vector_type(4)));
typedef unsigned u32x4 __attribute__((ext_vector_type(4)));
constexpr int BM = 256, BK = 64, HALF = 128, HTB = HALF * BK * 2  , STAGE_BYTES = 8 * HTB, NXCD = 8, WGM = 8;

__host__ __device__ __forceinline__ int lds_byte(int r, int c) { const int st = (r >> 4) * 2 + (c >> 5), rr = r & 15, cc = c & 31, ob = rr * 64 + cc * 2; return st * 1024 + (ob ^ (((ob >> 9) & 1) << 5)); }
__host__ __device__ __forceinline__ void stage_rc(int b, int& R, int& C) { const int st = b / 1024, sb = b % 1024, swz = sb ^ (((sb >> 9) & 1) << 5); R = (st >> 1) * 16 + swz / 64; C = (st & 1) * 32 + (swz % 64) / 2; }
__host__ __device__ __forceinline__ int perm32(int rho) { const int n = rho >> 4, i = rho & 15; return 8 * (i >> 2) + 4 * n + (i & 3); }

struct Unit { int pm, pn; };
struct Gemm { const bf16_t* A; const bf16_t* Bt; int M, N, K; };

struct StaticOrder {
    int nM, nN, nwg, G, c;
    __host__ __device__ void init(int M, int N, int G_, int c_) { nM = M / BM; nN = N / BM; nwg = nM * nN; G = G_; c = c_; }
    __host__ __device__ bool next(int i, Unit& u) const {
        const long L = (long)i * G + c; if (L >= nwg) return false;
        int wgid = (int)L; { const int q = nwg / NXCD, r = nwg % NXCD, xcd = wgid % NXCD, off = wgid / NXCD; wgid = (xcd < r ? xcd * (q + 1) : r * (q + 1) + (xcd - r) * q) + off; }
        const int nig = WGM * nN, gid = wgid / nig, fm = gid * WGM, gsz = (nM - fm) < WGM ? (nM - fm) : WGM;
        u.pm = fm + ((wgid % nig) % gsz); u.pn = (wgid % nig) / gsz; return true;
    }
    __device__ __forceinline__ void a_ready(const Unit&) const {}
    __device__ __forceinline__ void done(const Unit&) const {}
};
__device__ __forceinline__ unsigned cvt_pk_bf16(float lo, float hi) { unsigned r; asm volatile("v_cvt_pk_bf16_f32 %0, %1, %2" : "=v"(r) : "v"(lo), "v"(hi)); return r; }
template <class Epi, class Sched, bool STAMP = false>
__device__ __forceinline__ void gemm_phase(PG8_LAS unsigned char* lds, const Gemm g, const Sched& S, const Epi& E, unsigned long long* stamps) {
    const int tid = threadIdx.x, wid = __builtin_amdgcn_readfirstlane(tid >> 6), lane = tid & 63, wr = wid >> 2, wc = wid & 3, fr = lane & 15, fq = lane >> 4;
    const int K = g.K, nt = K / BK;
    int ts_lo = 0, ts_hi = 0, nts = 0; const unsigned long long rt_entry = STAMP ? (unsigned long long)wall_clock64() : 0ull;
#define PG8_STAMP() do { if (STAMP && wid == 0 && nts < 64) { const unsigned long long _c = (unsigned long long)clock64(); \
        ts_lo = (lane == nts) ? (int)(unsigned)_c : ts_lo; ts_hi = (lane == nts) ? (int)(unsigned)(_c >> 32) : ts_hi; ++nts; } } while (0)
    PG8_STAMP();
    unsigned voffA[2], voffB[2];
#pragma unroll
    for (int i = 0; i < 2; ++i) { int R, C; stage_rc(tid * 16 + i * 8192, R, C); const int Rb = Epi::PERM ? ((R & ~31) + perm32(R & 31)) : R;
        voffA[i] = (unsigned)(R * K + C) * 2u; voffB[i] = (unsigned)(Rb * K + C) * 2u; }
    const size_t kstep = (size_t)(BK * 2);
    const size_t hstep = (size_t)HALF * K * 2;
    const size_t tstep = 2 * hstep;
    const unsigned ldsw = (unsigned)wid * 1024u;
    const int aoff = lds_byte(wr * 64 + fr, fq * 8), boff = lds_byte(wc * 32 + fr, fq * 8);
#define PG8_SA(b, h) (((b) * 2 + (h)) * HTB)
#define PG8_SB(b, h) ((4 + (b) * 2 + (h)) * HTB)
#define PG8_STAGE(bufoff, gbase, voff) do { _Pragma("unroll") for (int _i = 0; _i < 2; ++_i) \
        __builtin_amdgcn_global_load_lds((const unsigned*)((const char*)(gbase) + (voff)[_i]), (PG8_LAS unsigned*)(lds + (bufoff) + ldsw + _i * 8192), 16, 0, 0); } while (0)
#define PG8_LDA(dst, b, h) do { _Pragma("unroll") for (int m = 0; m < 4; ++m) _Pragma("unroll") for (int k = 0; k < 2; ++k) dst[m][k] = *(const PG8_LAS bf16x8*)(lds + PG8_SA(b, h) + aoff + m * 2048 + k * 1024); } while (0)
#define PG8_LDB(dst, b, h) do { _Pragma("unroll") for (int n = 0; n < 2; ++n) _Pragma("unroll") for (int k = 0; k < 2; ++k) dst[n][k] = *(const PG8_LAS bf16x8*)(lds + PG8_SB(b, h) + boff + n * 2048 + k * 1024); } while (0)
#define PG8_MMA(ai, bj, At, Bt) do { __builtin_amdgcn_s_setprio(1); _Pragma("unroll") for (int m = 0; m < 4; ++m) _Pragma("unroll") for (int n = 0; n < 2; ++n) _Pragma("unroll") for (int k = 0; k < 2; ++k) \
        acc[ai][bj][m][n] = __builtin_amdgcn_mfma_f32_16x16x32_bf16(Bt[n][k], At[m][k], acc[ai][bj][m][n], 0, 0, 0); __builtin_amdgcn_s_setprio(0); } while (0)
#define PG8_WAIT_V(n) asm volatile("s_waitcnt vmcnt(" #n ")" ::: "memory")
#define PG8_WAIT_L(n) asm volatile("s_waitcnt lgkmcnt(" #n ")" ::: "memory")
#define PG8_BAR __builtin_amdgcn_s_barrier()
#define PG8_SCHED __builtin_amdgcn_sched_barrier(0)
    Unit cur, nxt; int ui = 0;
    if (!S.next(0, cur)) return;
    f32x4 acc[2][2][4][2];
#pragma unroll
    for (int a = 0; a < 2; ++a)
#pragma unroll
        for (int b = 0; b < 2; ++b)
#pragma unroll
            for (int m = 0; m < 4; ++m)
#pragma unroll
                for (int n = 0; n < 2; ++n) acc[a][b][m][n] = (f32x4){0.f, 0.f, 0.f, 0.f};
    bf16x8 At[4][2], B0[2][2], B1[2][2];
    const char* cA = (const char*)g.A + (size_t)cur.pm * tstep; const char* cB = (const char*)g.Bt + (size_t)cur.pn * tstep;
    S.a_ready(cur);
    PG8_STAGE(PG8_SB(0, 0), cB, voffB); PG8_STAGE(PG8_SA(0, 0), cA, voffA); PG8_STAGE(PG8_SB(0, 1), cB + hstep, voffB); PG8_STAGE(PG8_SA(0, 1), cA + hstep, voffA);
    if (wr == 1) PG8_BAR;
    PG8_WAIT_V(4); PG8_BAR;
    PG8_STAGE(PG8_SB(1, 0), cB + kstep, voffB); PG8_STAGE(PG8_SA(1, 0), cA + kstep, voffA); PG8_STAGE(PG8_SB(1, 1), cB + hstep + kstep, voffB);
    PG8_WAIT_V(6); PG8_BAR;
    PG8_STAMP();
    for (;;) {
        const bool has_next = S.next(ui + 1, nxt);
        const char* nA = has_next ? (const char*)g.A + (size_t)nxt.pm * tstep : cA; const char* nB = has_next ? (const char*)g.Bt + (size_t)nxt.pn * tstep : cB;
        for (int t = 0; t < nt; t += 2) {
            const bool last = (t == nt - 2);
            const char* a1 = cA + (size_t)(t + 1) * kstep;
            const char* a2 = last ? nA : cA + (size_t)(t + 2) * kstep; const char* b2 = last ? nB : cB + (size_t)(t + 2) * kstep;
            const char* a3 = a2 + kstep; const char* b3 = b2 + kstep;
            if (last && has_next) S.a_ready(nxt);
            PG8_LDB(B0, 0, 0); PG8_SCHED; PG8_LDA(At, 0, 0); PG8_STAGE(PG8_SA(1, 1), a1 + hstep, voffA);
            PG8_WAIT_L(8); PG8_BAR; PG8_WAIT_L(0); PG8_MMA(0, 0, At, B0); PG8_BAR; PG8_SCHED;
            PG8_LDB(B1, 0, 1); PG8_STAGE(PG8_SB(0, 0), b2, voffB);
            PG8_BAR; PG8_WAIT_L(0); PG8_MMA(0, 1, At, B1); PG8_BAR;
            PG8_LDA(At, 0, 1); PG8_STAGE(PG8_SA(0, 0), a2, voffA);
            PG8_BAR; PG8_WAIT_L(0); PG8_MMA(1, 0, At, B0); PG8_BAR; PG8_SCHED;
            PG8_STAGE(PG8_SB(0, 1), b2 + hstep, voffB);
            PG8_WAIT_V(6); PG8_BAR; PG8_MMA(1, 1, At, B1); PG8_BAR;
            PG8_LDB(B0, 1, 0); PG8_SCHED; PG8_LDA(At, 1, 0); PG8_STAGE(PG8_SA(0, 1), a2 + hstep, voffA);
            PG8_WAIT_L(8); PG8_BAR; PG8_WAIT_L(0); PG8_MMA(0, 0, At, B0); PG8_BAR; PG8_SCHED;
            PG8_LDB(B1, 1, 1); PG8_STAGE(PG8_SB(1, 0), b3, voffB);
            PG8_BAR; PG8_WAIT_L(0); PG8_MMA(0, 1, At, B1); PG8_BAR;
            PG8_LDA(At, 1, 1); PG8_STAGE(PG8_SA(1, 0), a3, voffA);
            PG8_BAR; PG8_WAIT_L(0); PG8_MMA(1, 0, At, B0); PG8_BAR; PG8_SCHED;
            PG8_STAGE(PG8_SB(1, 1), b3 + hstep, voffB);
            PG8_WAIT_V(6); PG8_BAR; PG8_MMA(1, 1, At, B1); PG8_BAR;
        }
        PG8_STAMP();
        if constexpr (!Epi::AFTER_DRAIN) { E(acc, cur, wr, wc, fr, fq); S.done(cur); }
        PG8_STAMP();
        if (!has_next) break;
#pragma unroll
        for (int a = 0; a < 2; ++a)
#pragma unroll
            for (int b = 0; b < 2; ++b)
#pragma unroll
                for (int m = 0; m < 4; ++m)
#pragma unroll
                    for (int n = 0; n < 2; ++n) acc[a][b][m][n] = (f32x4){0.f, 0.f, 0.f, 0.f};
        cur = nxt; cA = nA; cB = nB; ++ui;
    }
    PG8_WAIT_V(0);
    if (wr == 0) PG8_BAR;
    PG8_BAR;
    if constexpr (Epi::AFTER_DRAIN) { E.fused(acc, cur, wr, wc, fr, fq, lds, wid, lane); S.done(cur); }
    PG8_STAMP();
    if (STAMP && wid == 0) { stamps[lane] = lane < nts ? (((unsigned long long)(unsigned)ts_hi << 32) | (unsigned)ts_lo) : 0ull;
        if (lane == 62) stamps[62] = rt_entry; if (lane == 63) stamps[63] = (unsigned long long)wall_clock64(); }
#undef PG8_STAMP
#undef PG8_SA
#undef PG8_SB
#undef PG8_STAGE
#undef PG8_LDA
#undef PG8_LDB
#undef PG8_MMA
#undef PG8_WAIT_V
#undef PG8_WAIT_L
#undef PG8_BAR
#undef PG8_SCHED
}
}
using namespace pg8;
#define LAS PG8_LAS
typedef float f32x16 __attribute__((ext_vector_type(16)));
typedef unsigned u32x2 __attribute__((ext_vector_type(2)));
typedef short s16x4 __attribute__((ext_vector_type(4)));

constexpr int NB = 16, SEQ = 2048, DM = 1024, MROWS = NB * SEQ, NPROJ = 4096, NH = 8, HD = 64;
constexpr float DN_ALPHA = 1.189207115002721f;
constexpr float LN_EPS = 1e-5f;
constexpr int LDS_BYTES = STAGE_BYTES;
constexpr size_t WS_CTL = 0;
constexpr size_t WS_MOD = 4096;
constexpr size_t WS_ROPE = WS_MOD + (size_t)NB * 3 * DM * 4;
constexpr size_t WS_KSUM = WS_ROPE + (size_t)SEQ * 32 * 2 * 4;
constexpr size_t WS_WIN = WS_KSUM + (size_t)128 * 2 * 512 * 4;
constexpr size_t WS_WOUT = WS_WIN + (size_t)NPROJ * DM * 2;
constexpr size_t WS_H = WS_WOUT + (size_t)DM * DM * 2;
constexpr size_t WS_QKV = WS_H + (size_t)MROWS * DM * 2;
constexpr size_t QKV_T = (size_t)NB * NH * SEQ * HD;
constexpr size_t WS_SG = WS_QKV + 6 * QKV_T * 2;
constexpr size_t WS_END = WS_SG + (size_t)MROWS * DM * 2;

struct Params { const float* x; const float* c; const float* w_in; const float* w_out; const float* w_ada; const float* b_ada; const float* ln_g; const float* ln_b; float* out; unsigned char* ws; };

__device__ __forceinline__ unsigned pk2(float lo, float hi) { return cvt_pk_bf16(lo, hi); }
__device__ __forceinline__ float bf2f(unsigned short b) { return __uint_as_float(((unsigned)b) << 16); }
__device__ __forceinline__ int sigma_col(int j) { return (j & ~0x30) | ((j & 0x10) << 1) | ((j & 0x20) >> 1); }

struct Epi1 {
    static constexpr bool PERM = false, AFTER_DRAIN = false;
    bf16_t* qkv; bf16_t* sg; const float* cosT; const float* sinT; float* ksum;
    __device__ __forceinline__ void operator()(const f32x4 (&acc)[2][2][4][2], const Unit& u, int wr, int wc, int fr, int fq) const {
        const int sec = u.pn >> 1, kind = sec & 3, ab = sec >> 2, b = u.pm >> 3;
        const bool isg = (kind == 3), isrope = (kind < 2), isk = (sec == 5);
        const int d0 = 16 * (wc & 1) + 4 * fq;
        const int hd0 = (u.pn & 1) * 4 + (wc >> 1);
        const int rl0 = wr * 64 + fr, sblk = (u.pm & 7) * 256;
        bf16_t* base; size_t rstride, hstride;
        if (isg) { base = sg + (size_t)u.pm * 256 * DM + ab * 512 + hd0 * 64 + d0; rstride = DM; hstride = 64; }
        else { base = qkv + (size_t)(ab * 3 + kind) * QKV_T + (((size_t)b * NH + hd0) * SEQ + sblk) * HD + d0; rstride = HD; hstride = (size_t)SEQ * HD; }
        f32x4 cs[2][2];
#pragma unroll
        for (int bj = 0; bj < 2; ++bj)
#pragma unroll
            for (int n = 0; n < 2; ++n) cs[bj][n] = (f32x4){0.f, 0.f, 0.f, 0.f};
#pragma unroll
        for (int ai = 0; ai < 2; ++ai)
#pragma unroll
            for (int m = 0; m < 4; ++m) {
                const int rl = rl0 + ai * 128 + m * 16;
                f32x4 c4 = (f32x4){1.f, 1.f, 1.f, 1.f}, s4 = (f32x4){0.f, 0.f, 0.f, 0.f};
                if (isrope) { c4 = *(const f32x4*)(cosT + (sblk + rl) * 32 + d0); s4 = *(const f32x4*)(sinT + (sblk + rl) * 32 + d0); }
#pragma unroll
                for (int bj = 0; bj < 2; ++bj) {
                    f32x4 t1 = acc[ai][bj][m][0], t2 = acc[ai][bj][m][1];
                    if (isg) {
#pragma unroll
                        for (int e = 0; e < 4; ++e) { t1[e] = t1[e] / (1.f + __expf(-t1[e])); t2[e] = t2[e] / (1.f + __expf(-t2[e])); }
                    }
                    const f32x4 o1 = t1 * c4 - t2 * s4, o2 = t1 * s4 + t2 * c4;
                    cs[bj][0] += o1; cs[bj][1] += o2;
                    bf16_t* rp = base + (size_t)rl * rstride + (size_t)(2 * bj) * hstride;
                    u32x2 w; w.x = pk2(o1[0], o1[1]); w.y = pk2(o1[2], o1[3]); *(u32x2*)rp = w;
                    w.x = pk2(o2[0], o2[1]); w.y = pk2(o2[2], o2[3]); *(u32x2*)(rp + 32) = w;
                }
            }
        if (isk) {
#pragma unroll
            for (int bj = 0; bj < 2; ++bj)
#pragma unroll
                for (int n = 0; n < 2; ++n)
#pragma unroll
                    for (int e = 0; e < 4; ++e) {
                        float v = cs[bj][n][e];
                        v += __shfl_xor(v, 1); v += __shfl_xor(v, 2); v += __shfl_xor(v, 4); v += __shfl_xor(v, 8);
                        cs[bj][n][e] = v;
                    }
            if (fr == 0) {
#pragma unroll
                for (int bj = 0; bj < 2; ++bj)
#pragma unroll
                    for (int n = 0; n < 2; ++n)
                        *(f32x4*)(ksum + ((size_t)u.pm * 2 + wr) * 512 + (hd0 + 2 * bj) * 64 + 32 * n + d0) = cs[bj][n];
            }
        }
    }
};

struct Epi2 {
    static constexpr bool PERM = false, AFTER_DRAIN = false;
    const float* x; const float* mod; float* out;
    __device__ __forceinline__ void operator()(const f32x4 (&acc)[2][2][4][2], const Unit& u, int wr, int wc, int fr, int fq) const {
        const int b = u.pm >> 3;
        const int row0 = u.pm * BM + wr * 64 + fr, col0 = u.pn * BM + wc * 32 + 4 * fq;
        f32x4 gv[2][2];
#pragma unroll
        for (int bj = 0; bj < 2; ++bj)
#pragma unroll
            for (int n = 0; n < 2; ++n) gv[bj][n] = *(const f32x4*)(mod + b * 3 * DM + 2 * DM + col0 + bj * HALF + n * 16);
#pragma unroll
        for (int ai = 0; ai < 2; ++ai)
#pragma unroll
            for (int m = 0; m < 4; ++m) {
                const size_t off = (size_t)(row0 + ai * HALF + m * 16) * DM + col0;
#pragma unroll
                for (int bj = 0; bj < 2; ++bj)
#pragma unroll
                    for (int n = 0; n < 2; ++n) {
                        const f32x4 xv = *(const f32x4*)(x + off + bj * HALF + n * 16);
                        *(f32x4*)(out + off + bj * HALF + n * 16) = xv * DN_ALPHA + gv[bj][n] * acc[ai][bj][m][n];
                    }
            }
    }
};
__device__ __forceinline__ void phase0(const Params& p, unsigned char* lds) {
    const int tid = threadIdx.x, gtid = blockIdx.x * 512 + tid, NT = gridDim.x * 512;
    unsigned char* ws = p.ws;
    float* mod = (float*)(ws + WS_MOD);
    if (gtid == 0) *(unsigned*)(ws + WS_CTL) = 0u;
    {
        float* cosT = (float*)(ws + WS_ROPE); float* sinT = cosT + SEQ * 32;
        for (int idx = gtid; idx < SEQ * 32; idx += NT) {
            const int s = idx >> 5, i = idx & 31;
            const float inv = (float)exp(-(double)i * (9.210340371976184 / 32.0));
            const float ang = (float)s * inv;
            const double n = rint((double)ang * 0.15915494309189535);
            const float r = (float)((double)ang - n * 6.283185307179586);
            cosT[idx] = cosf(r); sinT[idx] = sinf(r);
        }
    }
    {
        bf16_t* wt = (bf16_t*)(ws + WS_WIN);
        for (int idx = gtid; idx < NPROJ * 128; idx += NT) {
            const int kc = (idx >> 3) & 127, j = ((idx >> 10) << 3) | (idx & 7), n = sigma_col(j), k0 = kc * 8;
            float v[8];
#pragma unroll
            for (int e = 0; e < 8; ++e) v[e] = p.w_in[(size_t)(k0 + e) * NPROJ + n];
            u32x4 o; o.x = pk2(v[0], v[1]); o.y = pk2(v[2], v[3]); o.z = pk2(v[4], v[5]); o.w = pk2(v[6], v[7]);
            *(u32x4*)(wt + (size_t)j * DM + k0) = o;
        }
        bf16_t* wo = (bf16_t*)(ws + WS_WOUT);
        for (int idx = gtid; idx < DM * 128; idx += NT) {
            const int kc = (idx >> 3) & 127, n = ((idx >> 10) << 3) | (idx & 7), k0 = kc * 8;
            float v[8];
#pragma unroll
            for (int e = 0; e < 8; ++e) v[e] = p.w_out[(size_t)(k0 + e) * DM + n];
            u32x4 o; o.x = pk2(v[0], v[1]); o.y = pk2(v[2], v[3]); o.z = pk2(v[4], v[5]); o.w = pk2(v[6], v[7]);
            *(u32x4*)(wo + (size_t)n * DM + k0) = o;
        }
    }
    if (blockIdx.x < 192) {
        float* cs = (float*)lds;
        float* red = (float*)(lds + 65536);
        for (int i = tid; i < NB * DM; i += 512) cs[i] = p.c[i];
        __syncthreads();
        const int cl = tid & 15, col = blockIdx.x * 16 + cl, kg = tid >> 4;
        float a[16];
#pragma unroll
        for (int b = 0; b < 16; ++b) a[b] = 0.f;
        for (int kk = 0; kk < 32; ++kk) {
            const int k = kg * 32 + kk; const float w = p.w_ada[(size_t)k * (3 * DM) + col];
#pragma unroll
            for (int b = 0; b < 16; ++b) a[b] += cs[b * DM + k] * w;
        }
#pragma unroll
        for (int b = 0; b < 16; ++b) red[(kg * 16 + b) * 16 + cl] = a[b];
        __syncthreads();
        if (tid < 256) {
            const int b = tid >> 4, c2 = tid & 15; float s = 0.f;
            for (int g = 0; g < 32; ++g) s += red[(g * 16 + b) * 16 + c2];
            mod[b * 3 * DM + blockIdx.x * 16 + c2] = s + p.b_ada[blockIdx.x * 16 + c2];
        }
    }
}

__device__ __forceinline__ void phase1(const Params& p) {
    const int gtid = blockIdx.x * 512 + threadIdx.x, NT = gridDim.x * 512;
    const float* mod = (const float*)(p.ws + WS_MOD);
    bf16_t* h = (bf16_t*)(p.ws + WS_H);
    for (int idx = gtid; idx < MROWS * 128; idx += NT) {
        const int row = idx >> 7, c8 = (idx & 127) * 8, b = row >> 11;
        const f32x4 x0 = *(const f32x4*)(p.x + (size_t)row * DM + c8), x1 = *(const f32x4*)(p.x + (size_t)row * DM + c8 + 4);
        const f32x4 sh0 = *(const f32x4*)(mod + b * 3 * DM + c8), sh1 = *(const f32x4*)(mod + b * 3 * DM + c8 + 4);
        const f32x4 sc0 = *(const f32x4*)(mod + b * 3 * DM + DM + c8), sc1 = *(const f32x4*)(mod + b * 3 * DM + DM + c8 + 4);
        const f32x4 h0 = x0 * (sc0 + 1.f) + sh0, h1 = x1 * (sc1 + 1.f) + sh1;
        u32x4 o; o.x = pk2(h0[0], h0[1]); o.y = pk2(h0[2], h0[3]); o.z = pk2(h1[0], h1[1]); o.w = pk2(h1[2], h1[3]);
        *(u32x4*)(h + (size_t)row * DM + c8) = o;
    }
}

constexpr int VRS = 192;
constexpr int VIMG = 32 * VRS;
constexpr int N_ITEMS = 16384;
constexpr float SM_C = 0.18033688011112042f;

__device__ __forceinline__ s16x4 tr_read(unsigned a) { s16x4 r; asm volatile("ds_read_b64_tr_b16 %0, %1" : "=&v"(r) : "v"(a) : "memory"); return r; }

template <bool MOBA>
__device__ __forceinline__ void attn_item(const Params& p, LAS unsigned char* vimg, int it, int lane) {
    const int qi = lane & 31, hh = lane >> 5;
    int bh, q0, qs, ks, ntiles, u = 0, rcls = 0, own = 0, T = 0;
    if (MOBA) { T = 63 - (it >> 7); bh = it & 127; q0 = 32 * T; qs = 1; ks = 1; own = T >> 3; ntiles = T + 1; }
    else { u = 15 - (it >> 9); rcls = it & 3; bh = (it >> 2) & 127; q0 = 128 * u + rcls; qs = 4; ks = 4; ntiles = u + 1 + (u > 0 ? 6 : 3); }
    const int b = bh >> 3, hd = bh & 7;
    const bf16_t* qkv = (const bf16_t*)(p.ws + WS_QKV);
    const size_t hoff = ((size_t)b * NH + hd) * SEQ * HD;
    const bf16_t* qb = qkv + (size_t)(MOBA ? 3 : 0) * QKV_T + hoff;
    const bf16_t* kb = qkv + (size_t)(MOBA ? 4 : 1) * QKV_T + hoff;
    const bf16_t* vb = qkv + (size_t)(MOBA ? 5 : 2) * QKV_T + hoff;
    const int qpos = q0 + qs * qi;
    bf16x8 Qf[4];
#pragma unroll
    for (int s = 0; s < 4; ++s) Qf[s] = *(const bf16x8*)(qb + (size_t)qpos * HD + 16 * s + 8 * hh);

    unsigned selmask = 0, need = 0xffffffffu;
    if (MOBA) {
        if (own <= 3) selmask = (1u << own) - 1u;
        else {
            const float* ksum = (const float*)(p.ws + WS_KSUM);
            float g[7];
#pragma unroll
            for (int n = 0; n < 7; ++n) {
                g[n] = -3.0e38f;
                if (n < own) {
                    const float* k0p = ksum + ((size_t)(b * 8 + n) * 2) * 512 + hd * 64 + 8 * hh;
                    float a = 0.f;
#pragma unroll
                    for (int s = 0; s < 4; ++s) {
                        const f32x4 m0 = *(const f32x4*)(k0p + 16 * s) + *(const f32x4*)(k0p + 512 + 16 * s);
                        const f32x4 m1 = *(const f32x4*)(k0p + 16 * s + 4) + *(const f32x4*)(k0p + 512 + 16 * s + 4);
#pragma unroll
                        for (int e = 0; e < 4; ++e) { a += bf2f((unsigned short)Qf[s][e]) * m0[e]; a += bf2f((unsigned short)Qf[s][4 + e]) * m1[e]; }
                    }
                    a += __shfl_xor(a, 32);
                    g[n] = a;
                }
            }
#pragma unroll
            for (int r = 0; r < 3; ++r) {
                float best = -3.4e38f; int bi = 0;
#pragma unroll
                for (int n = 0; n < 7; ++n) { const bool ok = (n < own) && !((selmask >> n) & 1u) && (g[n] > best); best = ok ? g[n] : best; bi = ok ? n : bi; }
                selmask |= 1u << bi;
            }
        }
        unsigned nd = selmask;
#pragma unroll
        for (int o = 1; o < 64; o <<= 1) nd |= (unsigned)__shfl_xor((int)nd, o);
        need = (unsigned)__builtin_amdgcn_readfirstlane((int)nd) | (1u << own);
    }

    f32x16 O0, O1;
#pragma unroll
    for (int g = 0; g < 16; ++g) { O0[g] = 0.f; O1[g] = 0.f; }
    float mrun = -1.0e30f, lsum = 0.f;

    auto tile_k0 = [&](int tt) -> int {
        if (MOBA) return 32 * tt;
        if (tt <= u) return 128 * tt + rcls;
        const int xx = tt - (u + 1);
        const int ci = (u > 0) ? (xx >> 1) : xx, jt = (u > 0) ? (u - 1 + (xx & 1)) : 0;
        return 128 * jt + ((rcls + 1 + ci) & 3);
    };
    auto next_tile = [&](int tt) -> int {
        if (MOBA) { while (tt < ntiles && !((need >> (tt >> 3)) & 1u)) tt = (tt | 7) + 1; }
        return tt;
    };
    const int vrow = lane >> 3, vch = lane & 7;
    bf16x8 Kf[4]; u32x4 Vc[4];
    int tt = next_tile(0);
    {
        const int k0 = tile_k0(tt);
#pragma unroll
        for (int s = 0; s < 4; ++s) Kf[s] = *(const bf16x8*)(kb + (size_t)(k0 + ks * qi) * HD + 16 * s + 8 * hh);
#pragma unroll
        for (int i = 0; i < 4; ++i) Vc[i] = *(const u32x4*)(vb + (size_t)(k0 + ks * (vrow + 8 * i)) * HD + 8 * vch);
    }
    const unsigned vbase = (unsigned)(size_t)vimg;
    const unsigned tra = vbase + (unsigned)((4 * hh + ((lane & 15) >> 2)) * VRS + (16 * ((lane >> 4) & 1) + 4 * (lane & 3)) * 2);
    while (tt < ntiles) {
        const int k0 = tile_k0(tt);
        const int tn = next_tile(tt + 1);
#pragma unroll
        for (int i = 0; i < 4; ++i) *(LAS u32x4*)(vimg + (vrow + 8 * i) * VRS + 16 * vch) = Vc[i];
        bf16x8 Kc[4];
#pragma unroll
        for (int s = 0; s < 4; ++s) Kc[s] = Kf[s];
        if (tn < ntiles) {
            const int k1 = tile_k0(tn);
#pragma unroll
            for (int s = 0; s < 4; ++s) Kf[s] = *(const bf16x8*)(kb + (size_t)(k1 + ks * qi) * HD + 16 * s + 8 * hh);
#pragma unroll
            for (int i = 0; i < 4; ++i) Vc[i] = *(const u32x4*)(vb + (size_t)(k1 + ks * (vrow + 8 * i)) * HD + 8 * vch);
        }
        f32x16 S;
#pragma unroll
        for (int g = 0; g < 16; ++g) S[g] = 0.f;
#pragma unroll
        for (int s = 0; s < 4; ++s) S = __builtin_amdgcn_mfma_f32_32x32x16_bf16(Kc[s], Qf[s], S, 0, 0, 0);
        float tmax = S[0];
#pragma unroll
        for (int g = 1; g < 16; ++g) tmax = fmaxf(tmax, S[g]);
        tmax = fmaxf(tmax, __shfl_xor(tmax, 32));
        const float mnew = fmaxf(mrun, tmax * SM_C);
        const float alpha = __builtin_amdgcn_exp2f(mrun - mnew);
        mrun = mnew;
        const int dq = qpos - k0 - ks * 4 * hh;
        float lanew = 1.f;
        if (MOBA) { const int kblk = tt >> 3; lanew = (kblk == own) ? 1.f : (float)((selmask >> kblk) & 1u); }
        const bool is4 = (dq & 3) == 0;
        float psum = 0.f;
        unsigned Pp[8];
#pragma unroll
        for (int g = 0; g < 16; g += 2) {
            float pv[2];
#pragma unroll
            for (int z = 0; z < 2; ++z) {
                const int gg = g + z, cj = (gg & 3) + 8 * (gg >> 2);
                const int dist = dq - ks * cj;
                float w;
                if (MOBA) w = (dist >= 0) ? lanew : 0.f;
                else { const int wi = (dist <= 128 ? 1 : 0) + ((is4 && dist <= 512) ? 1 : 0) + (((dist & 15) == 0) ? 1 : 0); w = (dist >= 0) ? (float)wi : 0.f; }
                pv[z] = __builtin_amdgcn_exp2f(S[gg] * SM_C - mnew) * w;
                psum += pv[z];
            }
            Pp[g >> 1] = pk2(pv[0], pv[1]);
        }
        lsum = lsum * alpha + psum;
#pragma unroll
        for (int g = 0; g < 16; ++g) { O0[g] *= alpha; O1[g] *= alpha; }
        asm volatile("s_waitcnt lgkmcnt(0)" ::: "memory");
        s16x4 r000 = tr_read(tra), r001 = tr_read(tra + 8 * VRS), r010 = tr_read(tra + 16 * VRS), r011 = tr_read(tra + 24 * VRS);
        s16x4 r100 = tr_read(tra + 64), r101 = tr_read(tra + 64 + 8 * VRS), r110 = tr_read(tra + 64 + 16 * VRS), r111 = tr_read(tra + 64 + 24 * VRS);
        asm volatile("s_waitcnt lgkmcnt(0)" : "+v"(r000), "+v"(r001), "+v"(r010), "+v"(r011), "+v"(r100), "+v"(r101), "+v"(r110), "+v"(r111) :: "memory");
        bf16x8 V00, V01, V10, V11, P0, P1;
#pragma unroll
        for (int e = 0; e < 4; ++e) { V00[e] = r000[e]; V00[4 + e] = r001[e]; V01[e] = r010[e]; V01[4 + e] = r011[e]; V10[e] = r100[e]; V10[4 + e] = r101[e]; V11[e] = r110[e]; V11[4 + e] = r111[e]; }
        { u32x4 a; a.x = Pp[0]; a.y = Pp[1]; a.z = Pp[2]; a.w = Pp[3]; P0 = __builtin_bit_cast(bf16x8, a); a.x = Pp[4]; a.y = Pp[5]; a.z = Pp[6]; a.w = Pp[7]; P1 = __builtin_bit_cast(bf16x8, a); }
        O0 = __builtin_amdgcn_mfma_f32_32x32x16_bf16(V00, P0, O0, 0, 0, 0);
        O0 = __builtin_amdgcn_mfma_f32_32x32x16_bf16(V01, P1, O0, 0, 0, 0);
        O1 = __builtin_amdgcn_mfma_f32_32x32x16_bf16(V10, P0, O1, 0, 0, 0);
        O1 = __builtin_amdgcn_mfma_f32_32x32x16_bf16(V11, P1, O1, 0, 0, 0);
        tt = tn;
    }
    const float ltot = lsum + __shfl_xor(lsum, 32);
    const float linv = 1.f / ltot;
    const size_t row = (size_t)b * SEQ + qpos;
    const int colb = (MOBA ? 512 : 0) + hd * 64 + 4 * hh;
    const bf16_t* sgp = (const bf16_t*)(p.ws + WS_SG) + row * DM + colb;
    bf16_t* op = (bf16_t*)(p.ws + WS_H) + row * DM + colb;
#pragma unroll
    for (int t = 0; t < 2; ++t)
#pragma unroll
        for (int gq = 0; gq < 4; ++gq) {
            const u32x2 gw = *(const u32x2*)(sgp + 32 * t + 8 * gq);
            float o[4];
#pragma unroll
            for (int e = 0; e < 4; ++e) o[e] = (t ? O1[4 * gq + e] : O0[4 * gq + e]) * linv;
            o[0] *= __uint_as_float(gw.x << 16); o[1] *= __uint_as_float(gw.x & 0xffff0000u);
            o[2] *= __uint_as_float(gw.y << 16); o[3] *= __uint_as_float(gw.y & 0xffff0000u);
            u32x2 w; w.x = pk2(o[0], o[1]); w.y = pk2(o[2], o[3]);
            *(u32x2*)(op + 32 * t + 8 * gq) = w;
        }
}

__device__ __forceinline__ void phase3(const Params& p, LAS unsigned char* lds) {
    const int lane = threadIdx.x & 63, wave = __builtin_amdgcn_readfirstlane(threadIdx.x >> 6);
    LAS unsigned char* vimg = lds + wave * VIMG;
    unsigned* ctr = (unsigned*)(p.ws + WS_CTL);
    for (;;) {
        int it = 0;
        if (lane == 0) it = (int)atomicAdd(ctr, 1u);
        it = __builtin_amdgcn_readfirstlane(it);
        if (it >= N_ITEMS) break;
        if (it < 8192) attn_item<true>(p, vimg, it, lane);
        else attn_item<false>(p, vimg, it - 8192, lane);
    }
}

__device__ __forceinline__ float wave_sum(float v) {
#pragma unroll
    for (int o = 1; o < 64; o <<= 1) v += __shfl_xor(v, o);
    return v;
}
__device__ __forceinline__ void phase5(const Params& p) {
    const int lane = threadIdx.x & 63, gw = blockIdx.x * 8 + (threadIdx.x >> 6), NW = gridDim.x * 8;
    f32x4 gv[4], bv[4];
#pragma unroll
    for (int j = 0; j < 4; ++j) { gv[j] = *(const f32x4*)(p.ln_g + 256 * j + 4 * lane); bv[j] = *(const f32x4*)(p.ln_b + 256 * j + 4 * lane); }
    for (int row = gw; row < MROWS; row += NW) {
        float* rp = p.out + (size_t)row * DM + 4 * lane;
        f32x4 v[4]; float s = 0.f;
#pragma unroll
        for (int j = 0; j < 4; ++j) { v[j] = *(const f32x4*)(rp + 256 * j); s += (v[j][0] + v[j][1]) + (v[j][2] + v[j][3]); }
        const float mean = wave_sum(s) * (1.f / DM); float s2 = 0.f;
#pragma unroll
        for (int j = 0; j < 4; ++j) { v[j] = v[j] - mean; s2 += (v[j][0] * v[j][0] + v[j][1] * v[j][1]) + (v[j][2] * v[j][2] + v[j][3] * v[j][3]); }
        const float rstd = rsqrtf(wave_sum(s2) * (1.f / DM) + LN_EPS);
#pragma unroll
        for (int j = 0; j < 4; ++j) *(f32x4*)(rp + 256 * j) = v[j] * rstd * gv[j] + bv[j];
    }
}

__global__ void __launch_bounds__(512, 2) fwd_megakernel(Params p) {
    extern __shared__ __attribute__((aligned(16))) unsigned char lds_raw[];
    cg::grid_group grid = cg::this_grid();
    LAS unsigned char* lds = (LAS unsigned char*)lds_raw;
    unsigned char* ws = p.ws;
    phase0(p, lds_raw);
    grid.sync();
    phase1(p);
    grid.sync();
    {
        Gemm g; g.A = (const bf16_t*)(ws + WS_H); g.Bt = (const bf16_t*)(ws + WS_WIN); g.M = MROWS; g.N = NPROJ; g.K = DM;
        StaticOrder S; S.init(MROWS, NPROJ, (int)gridDim.x, (int)blockIdx.x);
        Epi1 E; E.qkv = (bf16_t*)(ws + WS_QKV); E.sg = (bf16_t*)(ws + WS_SG); E.cosT = (const float*)(ws + WS_ROPE); E.sinT = E.cosT + SEQ * 32; E.ksum = (float*)(ws + WS_KSUM);
        gemm_phase<Epi1, StaticOrder>(lds, g, S, E, nullptr);
    }
    grid.sync();
    phase3(p, lds);
    grid.sync();
    {
        Gemm g; g.A = (const bf16_t*)(ws + WS_H); g.Bt = (const bf16_t*)(ws + WS_WOUT); g.M = MROWS; g.N = DM; g.K = DM;
        StaticOrder S; S.init(MROWS, DM, (int)gridDim.x, (int)blockIdx.x);
        Epi2 E; E.x = p.x; E.mod = (const float*)(ws + WS_MOD); E.out = p.out;
        gemm_phase<Epi2, StaticOrder>(lds, g, S, E, nullptr);
    }
    grid.sync();
    phase5(p);
}

extern "C" void kernel_launch(void* const* d_in, const int* in_sizes, int n_in, void* d_out, int out_size, void* d_ws, size_t ws_size, hipStream_t stream) {
    static int grid_blocks = 0;
    if (grid_blocks == 0) {
        int dev = 0, cus = 0, per_cu = 0;
        hipGetDevice(&dev);
        hipDeviceGetAttribute(&cus, hipDeviceAttributeMultiprocessorCount, dev);
        if (hipFuncSetAttribute((const void*)fwd_megakernel, hipFuncAttributeMaxDynamicSharedMemorySize, LDS_BYTES) != hipSuccess) fprintf(stderr, "kernel_launch: hipFuncSetAttribute failed\n");
        if (hipOccupancyMaxActiveBlocksPerMultiprocessor(&per_cu, (const void*)fwd_megakernel, 512, LDS_BYTES) != hipSuccess || per_cu < 1) { fprintf(stderr, "kernel_launch: occupancy query gave %d\n", per_cu); per_cu = 1; }
        (void)hipGetLastError();
        if (cus <= 0) cus = 256;
        grid_blocks = cus * per_cu;
        if (ws_size < WS_END) fprintf(stderr, "kernel_launch: workspace too small (%zu < %zu)\n", ws_size, (size_t)WS_END);
    }
    Params p{};
    p.x = (const float*)d_in[0]; p.c = (const float*)d_in[1]; p.w_in = (const float*)d_in[2]; p.w_out = (const float*)d_in[3];
    p.w_ada = (const float*)d_in[4]; p.b_ada = (const float*)d_in[5]; p.ln_g = (const float*)d_in[6]; p.ln_b = (const float*)d_in[7];
    p.out = (float*)d_out; p.ws = (unsigned char*)d_ws;
    void* args[] = {&p};
    hipError_t e = hipLaunchCooperativeKernel((const void*)fwd_megakernel, dim3(grid_blocks), dim3(512), args, LDS_BYTES, stream);
    if (e != hipSuccess) fprintf(stderr, "cooperative launch failed: %s (grid %d)\n", hipGetErrorString(e), grid_blocks);
}
```
